# Optimizing an MI355X kernel written in HIP

```python
import jax, jax.numpy as jnp
from jax import lax
import numpy as np

D_MODEL = 1024
BATCH = 4
SEQ = 4096
DEPTH = 1

N_META = 16
HEAD_DIM = 64
ATTN_HEADS = 8
ATTN_WIDTH = ATTN_HEADS * HEAD_DIM
CONV_WIDTH = D_MODEL - ATTN_WIDTH
CONV_GROUPS = CONV_WIDTH // HEAD_DIM
CONV_K = 3
BLOCK_Q = 128
N_EXPERT_GROUPS = 4
EXPERTS_PER_GROUP = 8
N_EXPERTS = N_EXPERT_GROUPS * EXPERTS_PER_GROUP
TOP_K = 2
D_EXPERT = 512
EXPERT_BLOCK = 128
EPS = 1e-6
MASK_VALUE = -1e30
SPLIT_SIZES = (ATTN_WIDTH, ATTN_WIDTH, ATTN_WIDTH, ATTN_HEADS, CONV_WIDTH, CONV_WIDTH, CONV_WIDTH)
PROJ_COLS = sum(SPLIT_SIZES)
SPLIT_POINTS = tuple(int(p) for p in np.cumsum(SPLIT_SIZES)[:-1])

kernel_name = "hymba_fox_shortconv_hiermoe_block"


def rms_norm(x, g):
    xf = x.astype(jnp.float32)
    y = xf * lax.rsqrt(jnp.mean(xf * xf, axis=-1, keepdims=True) + EPS)
    return (y * g.astype(jnp.float32)).astype(x.dtype)


def forgetting_attention(q, k, v, log_f):
    Bsz, T, H, Dh = q.shape
    pad = (-T) % BLOCK_Q
    pw = ((0, 0), (pad, 0), (0, 0), (0, 0))
    q = jnp.pad(q, pw)
    k = jnp.pad(k, pw)
    v = jnp.pad(v, pw)
    log_f = jnp.pad(log_f, ((0, 0), (pad, 0), (0, 0)))
    Tp = T + pad
    nb = Tp // BLOCK_Q
    cum = jnp.cumsum(log_f, axis=1)
    cum_k = cum.transpose(0, 2, 1)
    k_pos = jnp.arange(Tp)
    k_valid = k_pos >= pad
    qb = q.reshape(Bsz, nb, BLOCK_Q, H, Dh).transpose(1, 0, 3, 2, 4)
    cq = cum.reshape(Bsz, nb, BLOCK_Q, H).transpose(1, 0, 3, 2)
    scale = Dh ** -0.5

    def block(args):
        i, qi, ci = args
        s = jnp.einsum('bhqd,bkhd->bhqk', qi, k).astype(jnp.float32) * scale
        s = s + ci[..., None] - cum_k[:, :, None, :]
        q_pos = i * BLOCK_Q + jnp.arange(BLOCK_Q)
        allowed = (k_pos[None, :] <= q_pos[:, None]) & k_valid[None, :]
        s = jnp.where(allowed, s, MASK_VALUE)
        p = jax.nn.softmax(s, axis=-1)
        return jnp.einsum('bhqk,bkhd->bqhd', p.astype(v.dtype), v)

    out = lax.map(block, (jnp.arange(nb), qb, cq))
    out = out.transpose(1, 0, 2, 3, 4).reshape(Bsz, Tp, H, Dh)
    return out[:, pad:]


def short_conv_mixer(b_gate, c_gate, hc, conv_w):
    u = c_gate * hc
    ch = u.shape[-1]
    y = lax.conv_general_dilated(
        u, conv_w[:, None, :].astype(u.dtype), window_strides=(1,),
        padding=[(CONV_K - 1, 0)], dimension_numbers=('NWC', 'WIO', 'NWC'),
        feature_group_count=ch)
    return b_gate * y


def hierarchical_moe(u, w_rg, b_rg, w_re, b_re, w_gate, w_up, w_down):
    Bsz, T, D = u.shape
    N = Bsz * T
    xt = u.reshape(N, D)
    g_prob = jax.nn.softmax((xt @ w_rg).astype(jnp.float32) + b_rg.astype(jnp.float32), axis=-1)
    g_p, g_idx = lax.top_k(g_prob, 1)
    e_logits = ((xt @ w_re).astype(jnp.float32) + b_re.astype(jnp.float32)).reshape(
        N, N_EXPERT_GROUPS, EXPERTS_PER_GROUP)
    e_logits = jnp.take_along_axis(e_logits, g_idx[:, :, None], axis=1)[:, 0]
    e_prob = jax.nn.softmax(e_logits, axis=-1)
    e_p, e_idx = lax.top_k(e_prob, TOP_K)
    gates = g_p * e_p / jnp.sum(e_p, axis=-1, keepdims=True)
    expert_ids = g_idx * EXPERTS_PER_GROUP + e_idx

    A = N * TOP_K
    flat_e = expert_ids.reshape(A)
    flat_tok = jnp.repeat(jnp.arange(N, dtype=jnp.int32), TOP_K)
    flat_w = gates.reshape(A)
    order = jnp.argsort(flat_e)
    se, stok, sw = flat_e[order], flat_tok[order], flat_w[order]
    counts = jnp.bincount(flat_e, length=N_EXPERTS)
    padded = (counts + EXPERT_BLOCK - 1) // EXPERT_BLOCK * EXPERT_BLOCK
    pad_end = jnp.cumsum(padded)
    pad_start = pad_end - padded
    start = jnp.cumsum(counts) - counts
    dest = pad_start[se] + jnp.arange(A) - start[se]
    n_blocks = -(-A // EXPERT_BLOCK) + N_EXPERTS
    R = n_blocks * EXPERT_BLOCK
    buf_tok = jnp.zeros((R,), jnp.int32).at[dest].set(stok)
    buf_w = jnp.zeros((R,), jnp.float32).at[dest].set(sw)
    block_e = jnp.minimum(
        jnp.searchsorted(pad_end, jnp.arange(n_blocks) * EXPERT_BLOCK, side='right'),
        N_EXPERTS - 1)
    xs = xt[buf_tok].reshape(n_blocks, EXPERT_BLOCK, D)

    def expert_block(args):
        xb, e = args
        hdn = jax.nn.silu(xb @ w_gate[e]) * (xb @ w_up[e])
        return hdn @ w_down[e]

    ys = lax.map(expert_block, (xs, block_e)).reshape(R, D)
    out = jax.ops.segment_sum(ys * buf_w[:, None].astype(ys.dtype), buf_tok, num_segments=N)
    return out.reshape(Bsz, T, D)


def hybrid_layer(h, g_mix, w_in, b_forget, q_norm_g, k_norm_g, conv_w, attn_out_g,
                 conv_out_g, w_out, g_ffn, w_rg, b_rg, w_re, b_re, w_gate, w_up, w_down):
    Bsz, T, _ = h.shape
    u = rms_norm(h, g_mix)
    proj = u @ w_in
    q, k, v, f_logit, b_gate, c_gate, hc = jnp.split(proj, SPLIT_POINTS, axis=-1)
    q = rms_norm(q.reshape(Bsz, T, ATTN_HEADS, HEAD_DIM), q_norm_g)
    k = rms_norm(k.reshape(Bsz, T, ATTN_HEADS, HEAD_DIM), k_norm_g)
    v = v.reshape(Bsz, T, ATTN_HEADS, HEAD_DIM)
    log_f = jax.nn.log_sigmoid(f_logit.astype(jnp.float32) + b_forget.astype(jnp.float32))
    attn = forgetting_attention(q, k, v, log_f)
    attn = rms_norm(attn, attn_out_g.reshape(ATTN_HEADS, HEAD_DIM)).reshape(Bsz, T, ATTN_WIDTH)
    conv = short_conv_mixer(b_gate, c_gate, hc, conv_w)
    conv = rms_norm(conv.reshape(Bsz, T, CONV_GROUPS, HEAD_DIM),
                    conv_out_g.reshape(CONV_GROUPS, HEAD_DIM)).reshape(Bsz, T, CONV_WIDTH)
    h = h + jnp.concatenate([attn, conv], axis=-1) @ w_out
    h = h + hierarchical_moe(rms_norm(h, g_ffn), w_rg, b_rg, w_re, b_re, w_gate, w_up, w_down)
    return h


def setup_inputs(seed: int = 0) -> dict:
    key = jax.random.key(seed)
    ks = jax.random.split(key, 20)

    def nrm(k, shape, scale):
        return jax.random.normal(k, shape, jnp.float32) * scale

    return {
        "x": nrm(ks[0], (BATCH, SEQ, D_MODEL), 1.0),
        "meta_tokens": nrm(ks[1], (N_META, D_MODEL), 1.0),
        "norm_mix_g": 1.0 + nrm(ks[2], (DEPTH, D_MODEL), 0.02),
        "w_in": nrm(ks[3], (DEPTH, D_MODEL, PROJ_COLS), D_MODEL ** -0.5),
        "b_forget": jax.random.uniform(ks[4], (DEPTH, ATTN_HEADS), jnp.float32, 1.0, 5.0),
        "q_norm_g": 1.0 + nrm(ks[5], (DEPTH, HEAD_DIM), 0.02),
        "k_norm_g": 1.0 + nrm(ks[6], (DEPTH, HEAD_DIM), 0.02),
        "conv_w": nrm(ks[7], (DEPTH, CONV_K, CONV_WIDTH), CONV_K ** -0.5),
        "attn_out_g": 1.0 + nrm(ks[8], (DEPTH, ATTN_WIDTH), 0.02),
        "conv_out_g": 1.0 + nrm(ks[9], (DEPTH, CONV_WIDTH), 0.02),
        "w_out": nrm(ks[10], (DEPTH, D_MODEL, D_MODEL), D_MODEL ** -0.5),
        "norm_ffn_g": 1.0 + nrm(ks[11], (DEPTH, D_MODEL), 0.02),
        "w_router_group": nrm(ks[12], (DEPTH, D_MODEL, N_EXPERT_GROUPS), D_MODEL ** -0.5),
        "b_router_group": nrm(ks[13], (DEPTH, N_EXPERT_GROUPS), 0.01),
        "w_router_expert": nrm(ks[14], (DEPTH, D_MODEL, N_EXPERTS), D_MODEL ** -0.5),
        "b_router_expert": nrm(ks[15], (DEPTH, N_EXPERTS), 0.01),
        "w_gate": nrm(ks[16], (DEPTH, N_EXPERTS, D_MODEL, D_EXPERT), D_MODEL ** -0.5),
        "w_up": nrm(ks[17], (DEPTH, N_EXPERTS, D_MODEL, D_EXPERT), D_MODEL ** -0.5),
        "w_down": nrm(ks[18], (DEPTH, N_EXPERTS, D_EXPERT, D_MODEL), D_EXPERT ** -0.5),
    }


def reference(x, meta_tokens, norm_mix_g, w_in, b_forget, q_norm_g, k_norm_g, conv_w,
              attn_out_g, conv_out_g, w_out, norm_ffn_g, w_router_group, b_router_group,
              w_router_expert, b_router_expert, w_gate, w_up, w_down):
    Bsz = x.shape[0]
    meta = jnp.broadcast_to(meta_tokens[None].astype(x.dtype), (Bsz, N_META, D_MODEL))
    h = jnp.concatenate([meta, x], axis=1)
    for layer in range(DEPTH):
        h = hybrid_layer(
            h, norm_mix_g[layer], w_in[layer], b_forget[layer], q_norm_g[layer],
            k_norm_g[layer], conv_w[layer], attn_out_g[layer], conv_out_g[layer],
            w_out[layer], norm_ffn_g[layer], w_router_group[layer], b_router_group[layer],
            w_router_expert[layer], b_router_expert[layer], w_gate[layer], w_up[layer],
            w_down[layer])
    return h[:, N_META:]
```

```cpp
#include <hip/hip_runtime.h>
#include <cstdio>
#include <cstdint>
namespace pg8 {
#define PG8_LAS __attribute__((address_space(3)))
typedef unsigned short bf16_t;
typedef short bf16x8 __attribute__((ext_vector_type(8)));
typedef float f32x4 __attribute__((ext_vector_type(4)));
typedef unsigned u32x4 __attribute__((ext_vector_type(4)));
constexpr int BM = 256, BK = 64, HALF = 128, HTB = HALF * BK * 2  , STAGE_BYTES = 8 * HTB, NXCD = 8, WGM = 8;

__host__ __device__ __forceinline__ int lds_byte(int r, int c) { const int st = (r >> 4) * 2 + (c >> 5), rr = r & 15, cc = c & 31, ob = rr * 64 + cc * 2; return st * 1024 + (ob ^ (((ob >> 9) & 1) << 5)); }
__host__ __device__ __forceinline__ void stage_rc(int b, int& R, int& C) { const int st = b / 1024, sb = b % 1024, swz = sb ^ (((sb >> 9) & 1) << 5); R = (st >> 1) * 16 + swz / 64; C = (st & 1) * 32 + (swz % 64) / 2; }
__host__ __device__ __forceinline__ int perm32(int rho) { const int n = rho >> 4, i = rho & 15; return 8 * (i >> 2) + 4 * n + (i & 3); }

struct Unit { int pm, pn; };
struct Gemm { const bf16_t* A; const bf16_t* Bt; int M, N, K; };

struct StaticOrder {
    int nM, nN, nwg, G, c;
    __host__ __device__ void init(int M, int N, int G_, int c_) { nM = M / BM; nN = N / BM; nwg = nM * nN; G = G_; c = c_; }
    __host__ __device__ bool next(int i, Unit& u) const {
        const long L = (long)i * G + c; if (L >= nwg) return false;
        int wgid = (int)L; { const int q = nwg / NXCD, r = nwg % NXCD, xcd = wgid % NXCD, off = wgid / NXCD; wgid = (xcd < r ? xcd * (q + 1) : r * (q + 1) + (xcd - r) * q) + off; }
        const int nig = WGM * nN, gid = wgid / nig, fm = gid * WGM, gsz = (nM - fm) < WGM ? (nM - fm) : WGM;
        u.pm = fm + ((wgid % nig) % gsz); u.pn = (wgid % nig) / gsz; return true;
    }
    __device__ __forceinline__ void a_ready(const Unit&) const {}
    __device__ __forceinline__ void done(const Unit&) const {}
};

__device__ __forceinline__ unsigned cvt_pk_bf16(float lo, float hi) { unsigned r; asm volatile("v_cvt_pk_bf16_f32 %0, %1, %2" : "=v"(r) : "v"(lo), "v"(hi)); return r; }
typedef float f32x2 __attribute__((ext_vector_type(2)));
constexpr int TPP = 4224;
constexpr int POS0 = 64;
constexpr float RMS_EPS = 1e-6f;
constexpr float QSCALE = 0.125f * 1.4426950408889634f;
__device__ __forceinline__ unsigned pkbf(float lo, float hi) { return cvt_pk_bf16(lo, hi); }

struct EpiProj {
    static constexpr bool PERM = true, AFTER_DRAIN = false;
    bf16_t *Q, *K, *V, *BG, *UC; const float *gq, *gk;
    __device__ __forceinline__ void operator()(const f32x4 (&acc)[2][2][4][2], const Unit& u, int wr, int wc, int fr, int fq) const {
        const int pn = u.pn;
#pragma unroll
        for (int ai = 0; ai < 2; ++ai)
#pragma unroll
            for (int m = 0; m < 4; ++m) {
                const int mrow = u.pm * BM + ai * HALF + wr * 64 + m * 16 + fr;
                const size_t prow = (size_t)(mrow >> 12) * TPP + POS0 + (mrow & 4095);
                if (pn < 4) {
                    float ss = 0.f;
#pragma unroll
                    for (int bj = 0; bj < 2; ++bj)
#pragma unroll
                        for (int n = 0; n < 2; ++n) { const f32x4 x = acc[ai][bj][m][n]; ss += (x[0] * x[0] + x[1] * x[1]) + (x[2] * x[2] + x[3] * x[3]); }
                    ss += __shfl_xor(ss, 16); ss += __shfl_xor(ss, 32);
                    const float rs = __builtin_amdgcn_rsqf(ss * (1.0f / 64.0f) + RMS_EPS) * (pn < 2 ? QSCALE : 1.0f);
                    const float* g = (pn < 2) ? gq : gk;
                    bf16_t* dst = ((pn < 2) ? Q : K) + prow * 512 + (4 * (pn & 1) + wc) * 64 + 8 * fq;
#pragma unroll
                    for (int bj = 0; bj < 2; ++bj) {
                        const f32x4 g0 = *(const f32x4*)(g + 32 * bj + 8 * fq), g1 = *(const f32x4*)(g + 32 * bj + 8 * fq + 4);
                        const f32x4 v0 = acc[ai][bj][m][0] * g0 * rs, v1 = acc[ai][bj][m][1] * g1 * rs;
                        u32x4 w; w.x = pkbf(v0[0], v0[1]); w.y = pkbf(v0[2], v0[3]); w.z = pkbf(v1[0], v1[1]); w.w = pkbf(v1[2], v1[3]);
                        *(u32x4*)(dst + 32 * bj) = w; }
                } else if (pn < 8) {
                    bf16_t* dst = ((pn < 6) ? V : BG) + prow * 512 + (4 * (pn & 1) + wc) * 64 + 8 * fq;
#pragma unroll
                    for (int bj = 0; bj < 2; ++bj) {
                        const f32x4 v0 = acc[ai][bj][m][0], v1 = acc[ai][bj][m][1];
                        u32x4 w; w.x = pkbf(v0[0], v0[1]); w.y = pkbf(v0[2], v0[3]); w.z = pkbf(v1[0], v1[1]); w.w = pkbf(v1[2], v1[3]);
                        *(u32x4*)(dst + 32 * bj) = w; }
                } else {
                    bf16_t* dst = UC + prow * 512 + 128 * (pn - 8) + 32 * wc + 8 * fq;
                    const f32x4 v0 = acc[ai][0][m][0] * acc[ai][1][m][0], v1 = acc[ai][0][m][1] * acc[ai][1][m][1];
                    u32x4 w; w.x = pkbf(v0[0], v0[1]); w.y = pkbf(v0[2], v0[3]); w.z = pkbf(v1[0], v1[1]); w.w = pkbf(v1[2], v1[3]);
                    *(u32x4*)dst = w;
                }
            }
    }
};
struct EpiRes {
    static constexpr bool PERM = false, AFTER_DRAIN = false;
    const float* x; float* out;
    __device__ __forceinline__ void operator()(const f32x4 (&acc)[2][2][4][2], const Unit& u, int wr, int wc, int fr, int fq) const {
        const int col0 = u.pn * BM + wc * 32 + 4 * fq;
#pragma unroll
        for (int ai = 0; ai < 2; ++ai)
#pragma unroll
            for (int m = 0; m < 4; ++m) { const size_t off = (size_t)(u.pm * BM + ai * HALF + wr * 64 + m * 16 + fr) * 1024 + col0;
#pragma unroll
                for (int bj = 0; bj < 2; ++bj)
#pragma unroll
                    for (int n = 0; n < 2; ++n) { const f32x4 o = *(const f32x4*)(x + off + bj * HALF + n * 16) + acc[ai][bj][m][n]; *(f32x4*)(out + off + bj * HALF + n * 16) = o; } }
    }
};
struct EpiSwiGLU {
    static constexpr bool PERM = true, AFTER_DRAIN = false;
    bf16_t* Hd;
    __device__ __forceinline__ void operator()(const f32x4 (&acc)[2][2][4][2], const Unit& u, int wr, int wc, int fr, int fq) const {
        const int j = u.pn & 3;
#pragma unroll
        for (int ai = 0; ai < 2; ++ai)
#pragma unroll
            for (int m = 0; m < 4; ++m) {
                bf16_t* dst = Hd + (size_t)(u.pm * BM + ai * HALF + wr * 64 + m * 16 + fr) * 512 + 128 * j + 32 * wc + 8 * fq;
                f32x4 h[2];
#pragma unroll
                for (int n = 0; n < 2; ++n)
#pragma unroll
                    for (int i = 0; i < 4; ++i) { const float g = acc[ai][0][m][n][i], up = acc[ai][1][m][n][i];
                        h[n][i] = g * __builtin_amdgcn_rcpf(1.0f + __builtin_amdgcn_exp2f(-1.4426950408889634f * g)) * up; }
                u32x4 w; w.x = pkbf(h[0][0], h[0][1]); w.y = pkbf(h[0][2], h[0][3]); w.z = pkbf(h[1][0], h[1][1]); w.w = pkbf(h[1][2], h[1][3]);
                *(u32x4*)dst = w;
            }
    }
};
struct EpiDown {
    static constexpr bool PERM = true, AFTER_DRAIN = false;
    bf16_t* Y; const float* sgate;
    __device__ __forceinline__ void operator()(const f32x4 (&acc)[2][2][4][2], const Unit& u, int wr, int wc, int fr, int fq) const {
        const int j = u.pn & 3;
#pragma unroll
        for (int ai = 0; ai < 2; ++ai)
#pragma unroll
            for (int m = 0; m < 4; ++m) {
                const int row = u.pm * BM + ai * HALF + wr * 64 + m * 16 + fr;
                const float gt = sgate[row];
                bf16_t* dst = Y + (size_t)row * 1024 + 256 * j + 32 * wc + 8 * fq;
#pragma unroll
                for (int bj = 0; bj < 2; ++bj) {
                    const f32x4 v0 = acc[ai][bj][m][0] * gt, v1 = acc[ai][bj][m][1] * gt;
                    u32x4 w; w.x = pkbf(v0[0], v0[1]); w.y = pkbf(v0[2], v0[3]); w.z = pkbf(v1[0], v1[1]); w.w = pkbf(v1[2], v1[3]);
                    *(u32x4*)(dst + bj * HALF) = w; }
            }
    }
};
struct GroupedOrder {
    int n4, G, c; const PG8_LAS int* tile_e;
    __device__ __forceinline__ bool next(int i, Unit& u) const {
        const int L = i * G + c; if (L >= n4) return false;
        const int t = L >> 2; u.pm = t; u.pn = __builtin_amdgcn_readfirstlane(tile_e[t]) * 4 + (L & 3); return true;
    }
    __device__ __forceinline__ void a_ready(const Unit&) const {}
    __device__ __forceinline__ void done(const Unit&) const {}
};

template <class Epi, class Sched, bool ALIGN_EPI = false, bool SP2 = false>
__device__ __forceinline__ void gemm_phase(PG8_LAS unsigned char* lds, const Gemm g, const Sched& S, const Epi& E) {
    const int tid = threadIdx.x, wid = __builtin_amdgcn_readfirstlane(tid >> 6), lane = tid & 63, wr = wid >> 2, wc = wid & 3, fr = lane & 15, fq = lane >> 4;
    const int K = g.K, nt = K / BK;
    unsigned voffA[2], voffB[2];
#pragma unroll
    for (int i = 0; i < 2; ++i) { int R, C; stage_rc(tid * 16 + i * 8192, R, C); const int Rb = Epi::PERM ? ((R & ~31) + perm32(R & 31)) : R;
        voffA[i] = (unsigned)(R * K + C) * 2u; voffB[i] = (unsigned)(Rb * K + C) * 2u; }
    const size_t kstep = (size_t)(BK * 2);
    const size_t hstep = (size_t)HALF * K * 2;
    const size_t tstep = 2 * hstep;
    const unsigned ldsw = (unsigned)wid * 1024u;
    const int aoff = lds_byte(wr * 64 + fr, fq * 8), boff = lds_byte(wc * 32 + fr, fq * 8);
#define PG8_SA(b, h) (((b) * 2 + (h)) * HTB)
#define PG8_SB(b, h) ((4 + (b) * 2 + (h)) * HTB)
#define PG8_STAGE(bufoff, gbase, voff) do { _Pragma("unroll") for (int _i = 0; _i < 2; ++_i) \
        __builtin_amdgcn_global_load_lds((const unsigned*)((const char*)(gbase) + (voff)[_i]), (PG8_LAS unsigned*)(lds + (bufoff) + ldsw + _i * 8192), 16, 0, 0); } while (0)
#define PG8_LDA(dst, b, h) do { _Pragma("unroll") for (int m = 0; m < 4; ++m) _Pragma("unroll") for (int k = 0; k < 2; ++k) dst[m][k] = *(const PG8_LAS bf16x8*)(lds + PG8_SA(b, h) + aoff + m * 2048 + k * 1024); } while (0)
#define PG8_LDB(dst, b, h) do { _Pragma("unroll") for (int n = 0; n < 2; ++n) _Pragma("unroll") for (int k = 0; k < 2; ++k) dst[n][k] = *(const PG8_LAS bf16x8*)(lds + PG8_SB(b, h) + boff + n * 2048 + k * 1024); } while (0)
#define PG8_MMA(ai, bj, At, Bt) do { __builtin_amdgcn_s_setprio(1); _Pragma("unroll") for (int m = 0; m < 4; ++m) _Pragma("unroll") for (int n = 0; n < 2; ++n) _Pragma("unroll") for (int k = 0; k < 2; ++k) \
        acc[ai][bj][m][n] = __builtin_amdgcn_mfma_f32_16x16x32_bf16(Bt[n][k], At[m][k], acc[ai][bj][m][n], 0, 0, 0); __builtin_amdgcn_s_setprio(0); } while (0)
#define PG8_WAIT_V(n) asm volatile("s_waitcnt vmcnt(" #n ")" ::: "memory")
#define PG8_WAIT_L(n) asm volatile("s_waitcnt lgkmcnt(" #n ")" ::: "memory")
#define PG8_BAR __builtin_amdgcn_s_barrier()
#define PG8_SCHED __builtin_amdgcn_sched_barrier(0)
    Unit cur, nxt; int ui = 0;
    if (!S.next(0, cur)) return;
    f32x4 acc[2][2][4][2];
#pragma unroll
    for (int a = 0; a < 2; ++a)
#pragma unroll
        for (int b = 0; b < 2; ++b)
#pragma unroll
            for (int m = 0; m < 4; ++m)
#pragma unroll
                for (int n = 0; n < 2; ++n) acc[a][b][m][n] = (f32x4){0.f, 0.f, 0.f, 0.f};
    bf16x8 At[4][2], B0[2][2], B1[2][2];
    const char* cA = (const char*)g.A + (size_t)cur.pm * tstep; const char* cB = (const char*)g.Bt + (size_t)cur.pn * tstep;
    S.a_ready(cur);
    if constexpr (SP2) {
        PG8_STAGE(PG8_SB(0, 0), cB, voffB); PG8_STAGE(PG8_SB(0, 1), cB + hstep, voffB); PG8_STAGE(PG8_SA(0, 0), cA, voffA); PG8_STAGE(PG8_SA(0, 1), cA + hstep, voffA);
        if (wr == 1) PG8_BAR;
        PG8_WAIT_V(2); PG8_BAR;
        PG8_STAGE(PG8_SB(1, 0), cB + kstep, voffB); PG8_STAGE(PG8_SA(1, 0), cA + kstep, voffA); PG8_STAGE(PG8_SB(1, 1), cB + hstep + kstep, voffB);
        PG8_WAIT_V(6); PG8_BAR;
    } else {
        PG8_STAGE(PG8_SB(0, 0), cB, voffB); PG8_STAGE(PG8_SA(0, 0), cA, voffA); PG8_STAGE(PG8_SB(0, 1), cB + hstep, voffB); PG8_STAGE(PG8_SA(0, 1), cA + hstep, voffA);
        if (wr == 1) PG8_BAR;
        PG8_WAIT_V(4); PG8_BAR;
        PG8_STAGE(PG8_SB(1, 0), cB + kstep, voffB); PG8_STAGE(PG8_SA(1, 0), cA + kstep, voffA); PG8_STAGE(PG8_SB(1, 1), cB + hstep + kstep, voffB);
        PG8_WAIT_V(6); PG8_BAR;
    }
    for (;;) {
        const bool has_next = S.next(ui + 1, nxt);
        const char* nA = has_next ? (const char*)g.A + (size_t)nxt.pm * tstep : cA; const char* nB = has_next ? (const char*)g.Bt + (size_t)nxt.pn * tstep : cB;
        for (int t = 0; t < nt; t += 2) {
            const bool last = (t == nt - 2);
            const char* a1 = cA + (size_t)(t + 1) * kstep;
            const char* a2 = last ? nA : cA + (size_t)(t + 2) * kstep; const char* b2 = last ? nB : cB + (size_t)(t + 2) * kstep;
            const char* a3 = a2 + kstep; const char* b3 = b2 + kstep;
            if (last && has_next) S.a_ready(nxt);
            if constexpr (SP2) {
            PG8_LDB(B0, 0, 0); PG8_LDB(B1, 0, 1); PG8_SCHED; PG8_LDA(At, 0, 0); PG8_STAGE(PG8_SA(1, 1), a1 + hstep, voffA);
            PG8_WAIT_V(8); PG8_WAIT_L(0); PG8_BAR; PG8_MMA(0, 0, At, B0); PG8_MMA(0, 1, At, B1); PG8_BAR; PG8_SCHED;
            PG8_LDA(At, 0, 1); PG8_STAGE(PG8_SB(0, 0), b2, voffB); PG8_STAGE(PG8_SB(0, 1), b2 + hstep, voffB); PG8_STAGE(PG8_SA(0, 0), a2, voffA);
            PG8_WAIT_V(8); PG8_WAIT_L(0); PG8_BAR; PG8_MMA(1, 0, At, B0); PG8_MMA(1, 1, At, B1); PG8_BAR; PG8_SCHED;
            PG8_LDB(B0, 1, 0); PG8_LDB(B1, 1, 1); PG8_SCHED; PG8_LDA(At, 1, 0); PG8_STAGE(PG8_SA(0, 1), a2 + hstep, voffA);
            PG8_WAIT_V(8); PG8_WAIT_L(0); PG8_BAR; PG8_MMA(0, 0, At, B0); PG8_MMA(0, 1, At, B1); PG8_BAR; PG8_SCHED;
            PG8_LDA(At, 1, 1); PG8_STAGE(PG8_SB(1, 0), b3, voffB); PG8_STAGE(PG8_SB(1, 1), b3 + hstep, voffB); PG8_STAGE(PG8_SA(1, 0), a3, voffA);
            PG8_WAIT_V(8); PG8_WAIT_L(0); PG8_BAR; PG8_MMA(1, 0, At, B0); PG8_MMA(1, 1, At, B1); PG8_BAR; PG8_SCHED;
            } else {
            PG8_LDB(B0, 0, 0); PG8_SCHED; PG8_LDA(At, 0, 0); PG8_STAGE(PG8_SA(1, 1), a1 + hstep, voffA);
            PG8_WAIT_L(8); PG8_BAR; PG8_WAIT_L(0); PG8_MMA(0, 0, At, B0); PG8_BAR; PG8_SCHED;
            PG8_LDB(B1, 0, 1); PG8_STAGE(PG8_SB(0, 0), b2, voffB);
            PG8_BAR; PG8_WAIT_L(0); PG8_MMA(0, 1, At, B1); PG8_BAR;
            PG8_LDA(At, 0, 1); PG8_STAGE(PG8_SA(0, 0), a2, voffA);
            PG8_BAR; PG8_WAIT_L(0); PG8_MMA(1, 0, At, B0); PG8_BAR; PG8_SCHED;
            PG8_STAGE(PG8_SB(0, 1), b2 + hstep, voffB);
            PG8_WAIT_V(6); PG8_BAR; PG8_MMA(1, 1, At, B1); PG8_BAR;
            PG8_LDB(B0, 1, 0); PG8_SCHED; PG8_LDA(At, 1, 0); PG8_STAGE(PG8_SA(0, 1), a2 + hstep, voffA);
            PG8_WAIT_L(8); PG8_BAR; PG8_WAIT_L(0); PG8_MMA(0, 0, At, B0); PG8_BAR; PG8_SCHED;
            PG8_LDB(B1, 1, 1); PG8_STAGE(PG8_SB(1, 0), b3, voffB);
            PG8_BAR; PG8_WAIT_L(0); PG8_MMA(0, 1, At, B1); PG8_BAR;
            PG8_LDA(At, 1, 1); PG8_STAGE(PG8_SA(1, 0), a3, voffA);
            PG8_BAR; PG8_WAIT_L(0); PG8_MMA(1, 0, At, B0); PG8_BAR; PG8_SCHED;
            PG8_STAGE(PG8_SB(1, 1), b3 + hstep, voffB);
            PG8_WAIT_V(6); PG8_BAR; PG8_MMA(1, 1, At, B1); PG8_BAR;
            }
        }
        if constexpr (ALIGN_EPI) { if (wr == 0) PG8_BAR; }
        if constexpr (!Epi::AFTER_DRAIN) { E(acc, cur, wr, wc, fr, fq); S.done(cur); }
        if (!has_next) break;
#pragma unroll
        for (int a = 0; a < 2; ++a)
#pragma unroll
            for (int b = 0; b < 2; ++b)
#pragma unroll
                for (int m = 0; m < 4; ++m)
#pragma unroll
                    for (int n = 0; n < 2; ++n) acc[a][b][m][n] = (f32x4){0.f, 0.f, 0.f, 0.f};
        cur = nxt; cA = nA; cB = nB; ++ui;
        if constexpr (ALIGN_EPI) { if (wr == 1) PG8_BAR; }
    }
    PG8_WAIT_V(0);
    if constexpr (!ALIGN_EPI) { if (wr == 0) PG8_BAR; }
    PG8_BAR;
    if constexpr (Epi::AFTER_DRAIN) { E.fused(acc, cur, wr, wc, fr, fq, lds, wid, lane); S.done(cur); }
#undef PG8_SA
#undef PG8_SB
#undef PG8_STAGE
#undef PG8_LDA
#undef PG8_LDB
#undef PG8_MMA
#undef PG8_WAIT_V
#undef PG8_WAIT_L
#undef PG8_BAR
#undef PG8_SCHED
}
}

#ifndef PG8_SP2
#define PG8_SP2 true
#endif
#ifndef PG8_ALIGN
#define PG8_ALIGN true
#endif
#include <hip/hip_bf16.h>
#include <cmath>
namespace attn_body {
using bf16=__hip_bfloat16;
using bf16x8=__attribute__((ext_vector_type(8)))short;
using s16x4=__attribute__((ext_vector_type(4)))short;
using f32x16=__attribute__((ext_vector_type(16)))float;
using f32x4=__attribute__((ext_vector_type(4)))float;
using u32x4=__attribute__((ext_vector_type(4)))unsigned;
constexpr int NHEAD=8,D=64,DM=NHEAD*D;
constexpr int TPP=4224,POS0=64,KV0=48,SEQR=4096;
constexpr int NW=8,QBLK=32,QB=QBLK*NW,KVBLK=64;
__device__ __forceinline__ int crow(int r,int hi){return (r&3)+8*(r>>2)+4*hi;}
#define SBAR() __builtin_amdgcn_sched_barrier(0)
__device__ __forceinline__ void cmask(f32x16&p0,f32x16&p1,int jb,int qrel,int hi){
  const float NEG=-INFINITY; int kb=64*jb+4*hi;
  #pragma unroll
  for(int r=0;r<16;++r){int kv=kb+(r&3)+8*(r>>2); if(kv>qrel)p0[r]=NEG; if(kv+32>qrel)p1[r]=NEG;}
}

constexpr int NSLOT=3, SLOTB=8192;
constexpr int LDS_K=0, LDS_V=NSLOT*SLOTB, LDS_WS=2*NSLOT*SLOTB, LDS_OST=LDS_WS+NW*64*4, LDS_BIAS=LDS_OST+NW*8192, LDS_SCAN=LDS_BIAS+TPP*4, LDS_BYTES=LDS_SCAN+64;
__device__ __forceinline__ void glds16(const void*gsrc,unsigned lds_dst){unsigned keep;
  asm volatile("s_mov_b32 %0, m0\n\ts_mov_b32 m0, %2\n\ts_nop 0\n\tglobal_load_lds_dwordx4 %1, off\n\ts_mov_b32 m0, %0":"=&s"(keep):"v"(gsrc),"s"(lds_dst):"memory");}
__device__ __forceinline__ float max3f(float a,float b,float c){float r;asm("v_max3_f32 %0, %1, %2, %3":"=v"(r):"v"(a),"v"(b),"v"(c));return r;}
__device__ __forceinline__ float max2f(float a,float b){float r;asm("v_max_f32_e32 %0, %1, %2":"=v"(r):"v"(a),"v"(b));return r;}
__device__ __forceinline__ float fadd_s(float a,float b){float r;asm("v_add_f32_e32 %0, %1, %2":"=v"(r):"v"(a),"v"(b));return r;}
__device__ __forceinline__ float fsub_s(float a,float b){float r;asm("v_sub_f32_e32 %0, %1, %2":"=v"(r):"v"(a),"v"(b));return r;}
typedef float f32x2_t __attribute__((ext_vector_type(2))); typedef __bf16 bf16x2_t __attribute__((ext_vector_type(2)));
__device__ __forceinline__ unsigned cvtpk_s(float lo,float hi){f32x2_t v={lo,hi};bf16x2_t b=__builtin_convertvector(v,bf16x2_t);return __builtin_bit_cast(unsigned,b);}
#define WAIT_BAR(N) asm volatile("s_waitcnt vmcnt(" #N ") lgkmcnt(0)\n\ts_barrier":::"memory")

typedef __attribute__((address_space(3))) const char* lds_cptr;
typedef short v4i16_t __attribute__((ext_vector_type(4)));
__device__ __forceinline__ void binit(f32x16&c0,f32x16&c1,lds_cptr bp,float mhat){
  const __attribute__((address_space(3))) f32x4* p=(const __attribute__((address_space(3))) f32x4*)bp;
  #pragma unroll
  for(int g=0;g<4;++g){const f32x4 a=p[g],b=p[4+g];
    #pragma unroll
    for(int i=0;i<4;++i){c0[4*g+i]=a[i]-mhat;c1[4*g+i]=b[i]-mhat;}}
}
__device__ __forceinline__ void qkt(f32x16&p0,f32x16&p1,const char*Kslot,const bf16x8*qr,int r32,int hi){
  const char*kb=Kslot+hi*1024+r32*16;
  #pragma unroll
  for(int d0=0;d0<4;++d0){
    const bf16x8 b0=*reinterpret_cast<const bf16x8*>(kb+d0*2048);
    const bf16x8 b1=*reinterpret_cast<const bf16x8*>(kb+d0*2048+512);
    p0=__builtin_amdgcn_mfma_f32_32x32x16_bf16(b0,qr[d0],p0,0,0,0);p1=__builtin_amdgcn_mfma_f32_32x32x16_bf16(b1,qr[d0],p1,0,0,0);}
}
__device__ __forceinline__ void kload8(bf16x8*kf,lds_cptr kp){
  kf[0]=*(const __attribute__((address_space(3))) bf16x8*)(kp);      kf[1]=*(const __attribute__((address_space(3))) bf16x8*)(kp+512);
  kf[2]=*(const __attribute__((address_space(3))) bf16x8*)(kp+2048); kf[3]=*(const __attribute__((address_space(3))) bf16x8*)(kp+2560);
  kf[4]=*(const __attribute__((address_space(3))) bf16x8*)(kp+4096); kf[5]=*(const __attribute__((address_space(3))) bf16x8*)(kp+4608);
  kf[6]=*(const __attribute__((address_space(3))) bf16x8*)(kp+6144); kf[7]=*(const __attribute__((address_space(3))) bf16x8*)(kp+6656);
}
__device__ __forceinline__ void kload2(bf16x8*kf,lds_cptr kp,int j){ kf[2*j]=*(const __attribute__((address_space(3))) bf16x8*)(kp+j*2048); kf[2*j+1]=*(const __attribute__((address_space(3))) bf16x8*)(kp+j*2048+512); }
__device__ __forceinline__ s16x4 vtr(lds_cptr p){ return __builtin_bit_cast(s16x4,__builtin_amdgcn_ds_read_tr16_b64_v4i16((__attribute__((address_space(3))) v4i16_t*)p)); }
__device__ __forceinline__ float rowmax(const f32x16&p0,const f32x16&p1){
  float a=max3f(p0[0],p0[1],p1[0]),b=max3f(p0[2],p0[3],p1[1]);a=max3f(a,p1[2],p1[3]);
  #pragma unroll
  for(int r=4;r<16;r+=4){a=max3f(a,p0[r],p0[r+1]);b=max3f(b,p0[r+2],p0[r+3]);a=max3f(a,p1[r],p1[r+1]);b=max3f(b,p1[r+2],p1[r+3]);}
  const float m=max2f(a,b);
  auto rr=__builtin_amdgcn_permlane32_swap(__float_as_uint(m),__float_as_uint(m),false,false);
  return max2f(__uint_as_float(rr[0]),__uint_as_float(rr[1]));
}
__device__ __forceinline__ void pv(f32x16*o,int vb,bf16x8 pa0,bf16x8 pa1,bf16x8 pa2,bf16x8 pa3){
  #pragma unroll
  for(int d0=0;d0<2;++d0){s16x4 lo[4],hi[4];
    #pragma unroll
    for(int ks=0;ks<4;++ks){
      asm volatile("ds_read_b64_tr_b16 %0,%1 offset:%c2":"=&v"(lo[ks]):"v"(vb),"i"(d0*4096+ks*1024):"memory");
      asm volatile("ds_read_b64_tr_b16 %0,%1 offset:%c2":"=&v"(hi[ks]):"v"(vb),"i"(d0*4096+ks*1024+512):"memory");}
    asm volatile("s_waitcnt lgkmcnt(0)":::"memory");SBAR();
    #define PK(k) (bf16x8){lo[k][0],lo[k][1],lo[k][2],lo[k][3],hi[k][0],hi[k][1],hi[k][2],hi[k][3]}
    o[d0]=__builtin_amdgcn_mfma_f32_32x32x16_bf16(pa0,PK(0),o[d0],0,0,0);
    o[d0]=__builtin_amdgcn_mfma_f32_32x32x16_bf16(pa1,PK(1),o[d0],0,0,0);
    o[d0]=__builtin_amdgcn_mfma_f32_32x32x16_bf16(pa2,PK(2),o[d0],0,0,0);
    o[d0]=__builtin_amdgcn_mfma_f32_32x32x16_bf16(pa3,PK(3),o[d0],0,0,0);
    #undef PK
  }
}

template<int THRL> __device__ __forceinline__ void attn_unit(int b,int h,int qb,const bf16*Q,const bf16*__restrict__ K,const bf16*__restrict__ V,const float*__restrict__ LOGF,const float*__restrict__ ga,bf16*OUT,char*shm){
  const int tid=threadIdx.x,lane=tid&63,r32=lane&31,hi=lane>>5; const int wid=__builtin_amdgcn_readfirstlane(tid>>6);
  const long rowbase=(long)b*TPP; const int q0=POS0+qb*QB;
  const int NT=4*qb+6;
  const lds_cptr shm3=(lds_cptr)shm;
  { const float*lf=LOGF+((long)(b*NHEAD+h))*TPP; const int n=64*NT; const int e0=tid*12;
    float v[12];
    #pragma unroll
    for(int c=0;c<3;++c){ const int idx=e0+4*c; f32x4 x=(f32x4){0.f,0.f,0.f,0.f}; if(idx<n)x=*(const f32x4*)(lf+idx);
      #pragma unroll
      for(int i=0;i<4;++i){const int p=idx+i; v[4*c+i]=(p>=KV0&&p<TPP-64)?x[i]:0.f;} }
    float s=0.f;
    #pragma unroll
    for(int i=0;i<12;++i){s+=v[i];v[i]=s;}
    float x=s;
    #pragma unroll
    for(int o=1;o<64;o<<=1){const float y=__shfl_up(x,o); if(lane>=o)x+=y;}
    __attribute__((address_space(3))) float*sc=(__attribute__((address_space(3))) float*)(shm3+LDS_SCAN);
    if(lane==63)sc[wid]=x;
    asm volatile("s_waitcnt vmcnt(0) lgkmcnt(0)\n\ts_barrier":::"memory");
    float off=x-s;
    #pragma unroll
    for(int w=0;w<NW;++w){const float tw=sc[w]; if(w<wid)off+=tw;}
    __attribute__((address_space(3))) float*bt=(__attribute__((address_space(3))) float*)(shm3+LDS_BIAS);
    #pragma unroll
    for(int i=0;i<12;++i){const int p=e0+i; if(p<n){ const int w=p&63,ww=w&31; const int di=(p&~63)+((ww>>2)&1)*32+(w>>5)*16+((ww&3)|((ww>>3)<<2));
      bt[di]=(p<KV0)?-INFINITY:-(v[i]+off)*1.4426950408889634f; } }
  }
  const bf16*Qw=Q+(rowbase+q0+wid*QBLK)*DM+h*D;
  const bf16*Kh=K+rowbase*DM+h*D,*Vh=V+rowbase*DM+h*D;
  const unsigned lds0=(unsigned)(uintptr_t)shm;
  float*wsf=(float*)(shm+LDS_WS)+wid*64;
  const bf16*ksrc=Kh+(long)lane*DM+wid*8;
  const bf16*vsrc=Vh+(long)(16*(wid&3)+(lane>>2))*DM+(wid>>2)*32+(lane&3)*8;
  const unsigned kdst=lds0+LDS_K+wid*1024, vdst=lds0+LDS_V+wid*1024;
  #define DMA_K(t,slot) glds16(ksrc+(long)(t)*KVBLK*DM,(unsigned)__builtin_amdgcn_readfirstlane(kdst+(slot)))
  #define DMA_V(t,slot) glds16(vsrc+(long)(t)*KVBLK*DM,(unsigned)__builtin_amdgcn_readfirstlane(vdst+(slot)))
  const int vb0=(int)(lds0+LDS_V)+((lane>>4)&1)*32+(lane&3)*8+(4*hi+((lane&15)>>2))*64;
  const char*Kbase=shm+LDS_K; bf16x8 kf[8];
  const lds_cptr kp0=shm3+LDS_K+hi*1024+r32*16; const lds_cptr vp0=shm3+LDS_V+((lane>>4)&1)*32+(lane&3)*8+(4*hi+((lane&15)>>2))*64;
  const lds_cptr bp0=shm3+LDS_BIAS+hi*128;
  DMA_K(0,0);DMA_V(0,0);DMA_K(1,SLOTB);
  bf16x8 qr[4];
  #pragma unroll
  for(int d0=0;d0<4;++d0)qr[d0]=*reinterpret_cast<const bf16x8*>(&Qw[(long)r32*DM+d0*16+hi*8]);
  float mhat=0.f,l_reg=0.f;f32x16 o[2];o[0]=f32x16{};o[1]=f32x16{};
  const int qrel=wid*QBLK+r32;
  #define CMASK(P0,P1,t) do{int jb_=(t)-(NT-5); if(jb_>=0)cmask(P0,P1,jb_,qrel,hi);}while(0)
  bool resc=false;
  #define START(P0,P1) do{ const float rm=rowmax(P0,P1); resc=false; \
    { const float dl=rm; mhat=fadd_s(mhat,dl); \
      _Pragma("unroll") for(int r=0;r<16;++r){P0[r]=fsub_s(P0[r],dl);P1[r]=fsub_s(P1[r],dl);} } \
    _Pragma("unroll") for(int r=0;r<16;++r)P0[r]=__builtin_amdgcn_exp2f(P0[r]); }while(0)
  #define RESC() do{ if(resc){ asm volatile("s_waitcnt lgkmcnt(0)":::"memory"); \
      _Pragma("unroll") for(int d_=0;d_<2;++d_) _Pragma("unroll") for(int r=0;r<16;++r)o[d_][r]*=wsf[crow(r,hi)]; } }while(0)
  f32x16 pA0,pA1,pB0,pB1;
  int sl_prev=0,sl_cur=0,sl_next=SLOTB;
  #define ROT() do{sl_prev=sl_cur;sl_cur=sl_next;sl_next=(sl_next==(NSLOT-1)*SLOTB)?0:sl_next+SLOTB;}while(0)
  DMA_K(2,2*SLOTB);
  WAIT_BAR(3);
  binit(pA0,pA1,bp0,0.f);
  qkt(pA0,pA1,Kbase,qr,r32,hi);asm volatile("s_nop 15\n\ts_nop 7":"+v"(pA0),"+v"(pA1));
  START(pA0,pA1);
  _Pragma("unroll") for(int r=0;r<16;++r)pA1[r]=__builtin_amdgcn_exp2f(pA1[r]);
  WAIT_BAR(0);
  DMA_K(3,0);DMA_V(1,SLOTB);
  ROT();
  kload8(kf,kp0+sl_cur);
  WAIT_BAR(2);
  s16x4 vlo[8],vhi[8]; u32x4 pw0,pw1,pw2,pw3;
  #define PKW(P,B) cvtpk_s(P[B],P[B+1])
  #define PAF(k) __builtin_bit_cast(bf16x8,pw##k)
  #define VFR(i) (bf16x8){vlo[i][0],vlo[i][1],vlo[i][2],vlo[i][3],vhi[i][0],vhi[i][1],vhi[i][2],vhi[i][3]}
  #define PIN(x) asm volatile("":"+v"(x))
  #define MX3(a,b,c) __builtin_fmaxf(__builtin_fmaxf((a),(b)),(c))
  #define GAPA(MF,A0,A1,A2,A3,W0,W1,PW) do{ MF; sacc+=A0; sacc+=A1; sacc+=A2; sacc+=A3; PIN(sacc); W0; W1; PIN(PW); SBAR(); }while(0)
  #define EX(v) __builtin_amdgcn_exp2f(v)
  #define GAPB(MF,X,B) do{ MF; X[B]=EX(X[B]); X[B+1]=EX(X[B+1]); X[B+2]=EX(X[B+2]); X[B+3]=EX(X[B+3]); PIN(X); SBAR(); }while(0)
  #define VRD(i) do{ vlo[i]=vtr(vp_+(((i)>>2)*4096+((i)&3)*1024)); vhi[i]=vtr(vp_+(((i)>>2)*4096+((i)&3)*1024+512)); }while(0)
  #define KRD(G,j) do{ if(G){ kload2(kf,kp0+sl_next,j); SBAR(); } }while(0)
  #define STEP(C0,C1,P0,P1,t,GK,GV,GL) do{ SBAR(); \
    binit(C0,C1,bp0+(t)*256,mhat); SBAR(); \
    const lds_cptr vp_=vp0+sl_prev; \
    VRD(0); SBAR(); float sacc=(P0[0]+P0[1]); \
    GAPA(C0=__builtin_amdgcn_mfma_f32_32x32x16_bf16(kf[0],qr[0],C0,0,0,0), P0[2],P0[3],P0[4],P0[5],     pw0[0]=PKW(P0,0), pw0[1]=PKW(P0,2), pw0); \
    VRD(4); SBAR(); GAPA(C1=__builtin_amdgcn_mfma_f32_32x32x16_bf16(kf[1],qr[0],C1,0,0,0), P0[6],P0[7],P0[8],P0[9],     pw0[2]=PKW(P0,4), pw0[3]=PKW(P0,6), pw0); \
    VRD(1); SBAR(); GAPA(C0=__builtin_amdgcn_mfma_f32_32x32x16_bf16(kf[2],qr[1],C0,0,0,0),   P0[10],P0[11],P0[12],P0[13], pw1[0]=PKW(P0,8), pw1[1]=PKW(P0,10), pw1); \
    VRD(5); SBAR(); GAPA(C1=__builtin_amdgcn_mfma_f32_32x32x16_bf16(kf[3],qr[1],C1,0,0,0),   P0[14],P0[15],P1[0],P1[1],   pw1[2]=PKW(P0,12),pw1[3]=PKW(P0,14), pw1); \
    VRD(2); SBAR(); GAPA(C0=__builtin_amdgcn_mfma_f32_32x32x16_bf16(kf[4],qr[2],C0,0,0,0),   P1[2],P1[3],P1[4],P1[5],     pw2[0]=PKW(P1,0), pw2[1]=PKW(P1,2), pw2); \
    VRD(6); SBAR(); GAPA(C1=__builtin_amdgcn_mfma_f32_32x32x16_bf16(kf[5],qr[2],C1,0,0,0),   P1[6],P1[7],P1[8],P1[9],     pw2[2]=PKW(P1,4), pw2[3]=PKW(P1,6), pw2); \
    VRD(3); SBAR(); GAPA(C0=__builtin_amdgcn_mfma_f32_32x32x16_bf16(kf[6],qr[3],C0,0,0,0),   P1[10],P1[11],P1[12],P1[13], pw3[0]=PKW(P1,8), pw3[1]=PKW(P1,10), pw3); \
    VRD(7); SBAR(); GAPA(C1=__builtin_amdgcn_mfma_f32_32x32x16_bf16(kf[7],qr[3],C1,0,0,0),   P1[14],P1[15],0.f,0.f,       pw3[2]=PKW(P1,12),pw3[3]=PKW(P1,14), pw3); \
    l_reg+=sacc; \
    if(GK){DMA_K((t)+3,sl_cur);} if(GV){DMA_V((t)+1,sl_next);} \
    CMASK(C0,C1,t); \
    { float a=MX3(C0[0],C0[1],C1[0]),b=MX3(C0[2],C0[3],C1[1]); a=MX3(a,C1[2],C1[3]); \
      _Pragma("unroll") for(int r=4;r<16;r+=4){a=MX3(a,C0[r],C0[r+1]);b=MX3(b,C0[r+2],C0[r+3]);a=MX3(a,C1[r],C1[r+1]);b=MX3(b,C1[r+2],C1[r+3]);} \
      float rm=__builtin_fmaxf(a,b); { auto rr=__builtin_amdgcn_permlane32_swap(__float_as_uint(rm),__float_as_uint(rm),false,false); rm=__builtin_fmaxf(__uint_as_float(rr[0]),__uint_as_float(rr[1])); } \
      resc=false; \
      if(__builtin_expect(__any(rm>(float)THRL),0)){ const float dl=__builtin_fmaxf(rm,0.f); mhat+=dl; \
        _Pragma("unroll") for(int r=0;r<16;++r){C0[r]-=dl;C1[r]-=dl;} \
        const float f=__builtin_amdgcn_exp2f(-dl); l_reg*=f; if(hi==0)wsf[r32]=f; resc=true; } } \
    SBAR(); \
    GAPB(o[0]=__builtin_amdgcn_mfma_f32_32x32x16_bf16(PAF(0),VFR(0),o[0],0,0,0), C0,0); \
    GAPB(o[1]=__builtin_amdgcn_mfma_f32_32x32x16_bf16(PAF(0),VFR(4),o[1],0,0,0), C0,4); \
    KRD(GL,0); GAPB(o[0]=__builtin_amdgcn_mfma_f32_32x32x16_bf16(PAF(1),VFR(1),o[0],0,0,0), C0,8); \
    KRD(GL,1); GAPB(o[1]=__builtin_amdgcn_mfma_f32_32x32x16_bf16(PAF(1),VFR(5),o[1],0,0,0), C0,12); \
    KRD(GL,2); GAPB(o[0]=__builtin_amdgcn_mfma_f32_32x32x16_bf16(PAF(2),VFR(2),o[0],0,0,0), C1,0); \
    KRD(GL,3); GAPB(o[1]=__builtin_amdgcn_mfma_f32_32x32x16_bf16(PAF(2),VFR(6),o[1],0,0,0), C1,4); \
    GAPB(o[0]=__builtin_amdgcn_mfma_f32_32x32x16_bf16(PAF(3),VFR(3),o[0],0,0,0), C1,8); \
    GAPB(o[1]=__builtin_amdgcn_mfma_f32_32x32x16_bf16(PAF(3),VFR(7),o[1],0,0,0), C1,12); \
    }while(0)
  int t=1;
  #undef CMASK
  #define CMASK(P0,P1,t) do{}while(0)
  for(;t+5<NT;t+=2){
    STEP(pB0,pB1,pA0,pA1,t,true,true,true);     WAIT_BAR(2); RESC(); ROT();
    STEP(pA0,pA1,pB0,pB1,t+1,true,true,true);   WAIT_BAR(2); RESC(); ROT();
  }
  #undef CMASK
  #define CMASK(P0,P1,t) do{int jb_=(t)-(NT-5); if(jb_>=0)cmask(P0,P1,jb_,qrel,hi);}while(0)
  #define ENDW(tt) do{ if((tt)+3<NT){WAIT_BAR(2);} else if((tt)+2<NT){WAIT_BAR(1);} else {WAIT_BAR(0);} }while(0)
  for(;t+1<NT;t+=2){
    STEP(pB0,pB1,pA0,pA1,t,(t+3<NT),(t+1<NT),(t+1<NT));       ENDW(t);   RESC(); ROT();
    STEP(pA0,pA1,pB0,pB1,t+1,(t+4<NT),(t+2<NT),(t+2<NT));     ENDW(t+1); RESC(); ROT();
  }
  STEP(pB0,pB1,pA0,pA1,NT-1,false,false,false); RESC();
  { float sacc=pB0[0]+pB0[1]; _Pragma("unroll") for(int r=2;r<16;++r)sacc+=pB0[r]; _Pragma("unroll") for(int r=0;r<16;++r)sacc+=pB1[r]; l_reg+=sacc;
    pw0=(u32x4){PKW(pB0,0),PKW(pB0,2),PKW(pB0,4),PKW(pB0,6)};pw1=(u32x4){PKW(pB0,8),PKW(pB0,10),PKW(pB0,12),PKW(pB0,14)};pw2=(u32x4){PKW(pB1,0),PKW(pB1,2),PKW(pB1,4),PKW(pB1,6)};pw3=(u32x4){PKW(pB1,8),PKW(pB1,10),PKW(pB1,12),PKW(pB1,14)};
    SBAR(); pv(o,vb0+sl_cur,PAF(0),PAF(1),PAF(2),PAF(3)); }
  #undef PKW
  #undef PAF
  #undef VFR
  #undef PIN
  #undef MX3
  #undef GAPA
  #undef GAPB
  #undef EX
  #undef VRD
  #undef KRD
  #undef STEP
  #undef ENDW
  {auto rr=__builtin_amdgcn_permlane32_swap(__float_as_uint(l_reg),__float_as_uint(l_reg),false,false);l_reg=__uint_as_float(rr[0])+__uint_as_float(rr[1]);}
  if(hi==0)wsf[32+r32]=l_reg;asm volatile("s_waitcnt lgkmcnt(0)":::"memory");
  float rli[16];
  #pragma unroll
  for(int r=0;r<16;++r)rli[r]=__builtin_amdgcn_rcpf(wsf[32+crow(r,hi)]);
  bf16*Ow=OUT+((long)b*SEQR+qb*QB+wid*QBLK)*1024+h*D;
  { float*stg=(float*)(shm+LDS_OST)+wid*2048;
    #pragma unroll
    for(int r=0;r<16;++r){const int orow=crow(r,hi);
      #pragma unroll
      for(int d0=0;d0<2;++d0)stg[orow*64+d0*32+r32]=o[d0][r]*rli[r];}
    asm volatile("s_waitcnt lgkmcnt(0)":::"memory");
    const int ch=lane&7; const f32x4 g0=*(const f32x4*)(ga+h*D+ch*8),g1=*(const f32x4*)(ga+h*D+ch*8+4);
    #pragma unroll
    for(int i=0;i<4;++i){const int row=i*8+(lane>>3); const f32x4 a=*(const f32x4*)(stg+row*64+ch*8),c=*(const f32x4*)(stg+row*64+ch*8+4);
      float ss=(a[0]*a[0]+a[1]*a[1])+(a[2]*a[2]+a[3]*a[3])+(c[0]*c[0]+c[1]*c[1])+(c[2]*c[2]+c[3]*c[3]);
      ss+=__shfl_xor(ss,1);ss+=__shfl_xor(ss,2);ss+=__shfl_xor(ss,4);
      const float rs=__builtin_amdgcn_rsqf(ss*(1.0f/64.0f)+1e-6f);
      u32x4 v; v.x=cvtpk_s(a[0]*rs*g0[0],a[1]*rs*g0[1]); v.y=cvtpk_s(a[2]*rs*g0[2],a[3]*rs*g0[3]); v.z=cvtpk_s(c[0]*rs*g1[0],c[1]*rs*g1[1]); v.w=cvtpk_s(c[2]*rs*g1[2],c[3]*rs*g1[3]);
      *(u32x4*)(Ow+(long)row*1024+ch*8)=v;} }
  asm volatile("s_waitcnt lgkmcnt(0)\n\ts_barrier":::"memory");
  #undef DMA_K
  #undef DMA_V
  #undef CMASK
  #undef START
  #undef RESC
  #undef ROT
}
constexpr int ATTN_LDS_BYTES=LDS_BYTES;
struct AttnTensors { const bf16* Q; const bf16* K; const bf16* V; const float* LOGF; const float* ga; bf16* OUT; };
template<int THRL=8> __device__ __forceinline__ void attn_phase(char*lds,const AttnTensors&T,int vcu){
  const int s=vcu&7,bh=vcu>>3; if(bh>=32)return;
  attn_unit<THRL>(bh/NHEAD,bh%NHEAD,15-s,T.Q,T.K,T.V,T.LOGF,T.ga,T.OUT,lds);
  attn_unit<THRL>(bh/NHEAD,bh%NHEAD,s,T.Q,T.K,T.V,T.LOGF,T.ga,T.OUT,lds);
}
#undef SBAR
#undef WAIT_BAR
}
constexpr int NWAVES = 8;
#ifndef MK_SPLIT
#define MK_SPLIT 0
#endif
constexpr int NPHASE = 9;
constexpr int BATCH = 4, SEQ = 4096, NMETA = 16, DMODEL = 1024, NH = 8;
constexpr int MTOK = BATCH * SEQ;
constexpr int PCOLS = 3080;
constexpr int TPP = pg8::TPP, POS0 = pg8::POS0, KV0 = 48;
constexpr int NEXP = 32, DEXP = 512;
constexpr float EPS = 1e-6f;
static_assert(TPP == attn_body::TPP && POS0 == attn_body::POS0 && KV0 == attn_body::KV0, "position-space geometry");

constexpr size_t MiB = 1u << 20;
constexpr size_t WS_CTL = 0, CTL_ZERO_BYTES = 1 * MiB;
constexpr size_t WS_WIN = 1 * MiB, WS_WOUT = 7 * MiB, WS_WGU = 9 * MiB, WS_WD = 73 * MiB;
constexpr size_t WS_XN = 105 * MiB;
constexpr size_t WS_Q = 137 * MiB, WS_K = 154 * MiB, WS_V = 171 * MiB, WS_BG = 188 * MiB, WS_UC = 205 * MiB;
constexpr size_t WS_XS = 137 * MiB, WS_Y = 137 * MiB;
constexpr size_t WS_CAT = 222 * MiB, WS_HDN = 222 * MiB;
constexpr size_t WS_LOGF = 262 * MiB, WS_WRG = 263 * MiB, WS_LTOK = 264 * MiB, WS_LGATE = 266 * MiB, WS_SGATE = 268 * MiB, WS_SLOTOF = 268 * MiB + 256 * 1024;
constexpr size_t WS_END = 268 * MiB + 512 * 1024;
static_assert(WS_UC + (size_t)BATCH * TPP * 512 * 2 <= WS_CAT && WS_XS + (size_t)40960 * 1024 * 2 <= WS_CAT && WS_HDN + (size_t)40960 * 512 * 2 <= WS_LOGF, "d_ws map");
constexpr int CW_BAR = 4096;
constexpr int CW_CNT = 8192;
constexpr int CW_MACC = 16384;

constexpr int RING_OFF = 0, RING_BYTES = 135168;
constexpr int LDSCTL_OFF = RING_BYTES, MISC_OFF = LDSCTL_OFF + 320;
constexpr int TILE_OFF = MISC_OFF + 128;
constexpr int OFFS_OFF = TILE_OFF + 640;
constexpr int LDS_BYTES = 147456;
static_assert(OFFS_OFF + 4 * 72 <= LDS_BYTES && attn_body::ATTN_LDS_BYTES <= RING_BYTES && pg8::STAGE_BYTES <= RING_BYTES, "LDS map");

#define GAS __attribute__((address_space(1)))
#define LAS __attribute__((address_space(3)))
typedef unsigned short bf16;
typedef unsigned v4u __attribute__((ext_vector_type(4)));
typedef float f32x4 __attribute__((ext_vector_type(4)));
typedef short bf16x8 __attribute__((ext_vector_type(8)));
typedef GAS unsigned gu32;
typedef GAS unsigned long long gu64;
#define RLX_AGENT __ATOMIC_RELAXED, __HIP_MEMORY_SCOPE_AGENT
#define LDS_WAIT() asm volatile("s_waitcnt lgkmcnt(0)" ::: "memory")
#define VM_WAIT() asm volatile("s_waitcnt vmcnt(0)" ::: "memory")
__device__ __forceinline__ unsigned long long rt() { return __builtin_amdgcn_s_memrealtime(); }
__device__ __forceinline__ unsigned f2bf(float f) { unsigned u = __builtin_bit_cast(unsigned, f); return (u + 0x7fffu + ((u >> 16) & 1u)) >> 16; }
__device__ __forceinline__ unsigned pk2(float lo, float hi) { return f2bf(lo) | (f2bf(hi) << 16); }

#define XB_TMO      128
#define XB_XCNT(j)  (256  + 64 * (j))
#define XB_XSUB(j)  (1280 + 64 * (j))
#define XB_XGEN(j)  (2304 + 64 * (j))
#define XB_TOP      3328
#define XB_TOPGEN   3392
#define XCD_BAR_WORDS 3456
#define XB_SPIN_CAP (1u << 18)

__device__ __forceinline__ unsigned xb_ld(unsigned* p)              { return __hip_atomic_load(p, __ATOMIC_RELAXED, __HIP_MEMORY_SCOPE_AGENT); }
__device__ __forceinline__ unsigned xb_add(unsigned* p, unsigned v) { return __hip_atomic_fetch_add(p, v, __ATOMIC_RELAXED, __HIP_MEMORY_SCOPE_AGENT); }
__device__ __forceinline__ unsigned xb_xcc_id() { return (unsigned)__builtin_amdgcn_s_getreg((3 << 11) | 20) & 0xFu; }
#define XB_SPIN(cond, bar) do { unsigned _sp = 0; while (cond) { __builtin_amdgcn_s_sleep(1); \
    if ((++_sp & 255u) == 0u) { if (xb_ld(&(bar)[XB_TMO])) break; if (_sp > XB_SPIN_CAP) { atomicAdd(&(bar)[XB_TMO], 1u); break; } } } } while (0)

struct XcdBarrier {
    unsigned* bar; unsigned x;
    volatile LAS unsigned* st;
};

__device__ __forceinline__ XcdBarrier xcd_barrier_post(unsigned* bar, volatile LAS unsigned* st) {
    XcdBarrier b; b.bar = bar; b.x = xb_xcc_id(); b.st = st;
    if (threadIdx.x == 0) (void)xb_add(&bar[XB_XCNT(b.x)], 1u);
    return b;
}
__device__ __forceinline__ void xcd_barrier_complete(unsigned* bar, unsigned x, unsigned& nloc, unsigned& nx) {
    const unsigned G = gridDim.x * gridDim.y * gridDim.z;
    unsigned sum, cnt, mine, sp = 0u;
    for (;;) {
        sum = 0u; cnt = 0u; mine = 0u;
#pragma unroll
        for (unsigned j = 0; j < 16; ++j) { const unsigned c = xb_ld(&bar[XB_XCNT(j)]); sum += c; cnt += (c > 0u) ? 1u : 0u; mine = (j == x) ? c : mine; }
        if (sum == G) break;
        __builtin_amdgcn_s_sleep(1);
        if ((++sp & 255u) == 0u) { if (xb_ld(&bar[XB_TMO])) break; if (sp > XB_SPIN_CAP) { atomicAdd(&bar[XB_TMO], 1u); break; } }
    }
    nloc = mine > 0u ? mine : 1u; nx = cnt > 0u ? cnt : 1u;
}

__device__ __forceinline__ void xcd_barrier(const XcdBarrier& b) {
    asm volatile("s_waitcnt vmcnt(0)" ::: "memory");
    __syncthreads();
    if (threadIdx.x == 0) {
        unsigned* bar = b.bar;
        __builtin_amdgcn_s_waitcnt(0);
        unsigned nloc = b.st[0], nx = b.st[1];
        if (nloc == 0u) { xcd_barrier_complete(bar, b.x, nloc, nx); b.st[0] = nloc; b.st[1] = nx; }
        const unsigned old = xb_add(&bar[XB_XSUB(b.x)], 1u);
        const unsigned gen = old / nloc;
        if (old + 1u == (gen + 1u) * nloc) {
            __builtin_amdgcn_fence(__ATOMIC_RELEASE, "agent");
            asm volatile("s_waitcnt vmcnt(0)" ::: "memory");
            const unsigned og = xb_add(&bar[XB_TOP], 1u);
            const unsigned tg = og / nx;
            if (og + 1u == (tg + 1u) * nx) xb_add(&bar[XB_TOPGEN], 1u);
            else XB_SPIN(xb_ld(&bar[XB_TOPGEN]) == tg, bar);
            __builtin_amdgcn_fence(__ATOMIC_ACQUIRE, "agent");
            xb_add(&bar[XB_XGEN(b.x)], 1u);
            asm volatile("s_waitcnt vmcnt(0)" ::: "memory");
        } else {
            XB_SPIN(xb_ld(&bar[XB_XGEN(b.x)]) == gen, bar);
            __builtin_amdgcn_fence(__ATOMIC_ACQUIRE, "agent");
            asm volatile("s_waitcnt vmcnt(0)" ::: "memory");
        }
    }
    __syncthreads();
}

struct Frame {
    LAS unsigned char* lds;
    volatile LAS unsigned* MISC;
    gu32* ctl;
    int tid, lane, wave;
    int vcu, G;
    const float *x, *meta, *gmix, *w_in, *b_forget, *gq, *gk, *conv_w, *ga, *gc, *w_out, *gffn, *w_rg, *b_rg, *w_re, *b_re, *w_gate, *w_up, *w_down;
    float* out;
    bf16 *Win_t, *Wout_t, *Wgu_t, *Wd_t, *XN, *Q, *K, *V, *BG, *UC, *XS, *Y, *CAT, *HDN;
    float *LOGF, *WRG, *LGATE, *SGATE, *MACC; int *LTOK, *SLOTOF;
};
__device__ __forceinline__ float wave_sum(float v) {
#pragma unroll
    for (int o = 1; o < 64; o <<= 1) v += __shfl_xor(v, o);
    return v;
}
__device__ __forceinline__ float bf2f(unsigned short b) { return __builtin_bit_cast(float, (unsigned)b << 16); }
__device__ __forceinline__ float log_sigmoid(float z) { return fminf(z, 0.f) - log1pf(expf(-fabsf(z))); }

__device__ __forceinline__ void p0_transpose_item(const float* W, int ld, int K, bf16* WT, LAS float* scr, int k0, int lane) {
#pragma unroll 8
    for (int i = 0; i < 32; ++i) { const int kk = 2 * i + (lane >> 5); scr[kk * 33 + (lane & 31)] = W[(size_t)(k0 + kk) * ld + (lane & 31)]; }
    LDS_WAIT(); asm volatile("" ::: "memory");
    const int c = lane & 7;
#pragma unroll
    for (int j = 0; j < 4; ++j) { const int n = (lane >> 3) + 8 * j; const LAS float* s = scr + (8 * c) * 33 + n;
        v4u o; o.x = pk2(s[0 * 33], s[1 * 33]); o.y = pk2(s[2 * 33], s[3 * 33]); o.z = pk2(s[4 * 33], s[5 * 33]); o.w = pk2(s[6 * 33], s[7 * 33]);
        *(GAS v4u*)(WT + (size_t)n * K + k0 + 8 * c) = o; }
    LDS_WAIT(); asm volatile("" ::: "memory");
}
__device__ __forceinline__ int win_src_col(int g) {
    const int pn = g >> 3, bj = (g >> 2) & 1, wc = g & 3;
    if (pn < 8) { const int base = (pn < 2) ? 0 : (pn < 4) ? 512 : (pn < 6) ? 1024 : 1544; return base + (4 * (pn & 1) + wc) * 64 + 32 * bj; }
    return (bj ? 2568 : 2056) + 128 * (pn - 8) + 32 * wc;
}
__device__ __forceinline__ void p0_meta_item(Frame& F, LAS float* scr, int it) {
    const int lane = F.lane, cchunk = it % 49, kchunk = it / 49, k0 = 128 * kchunk;
    float rstd[16];
#pragma unroll
    for (int r = 0; r < 16; ++r) { const GAS f32x4* mr = (const GAS f32x4*)(F.meta + r * 1024) + lane; float ss = 0.f;
#pragma unroll
        for (int j = 0; j < 4; ++j) { const f32x4 v = mr[64 * j]; ss += (v.x * v.x + v.y * v.y) + (v.z * v.z + v.w * v.w); }
        rstd[r] = 1.0f / sqrtf(wave_sum(ss) * (1.0f / 1024.0f) + EPS); }
#pragma unroll
    for (int hf = 0; hf < 2; ++hf) { const int kk = lane + 64 * hf, k = k0 + kk; const float g = F.gmix[k];
#pragma unroll
        for (int r = 0; r < 16; ++r) scr[kk * 16 + r] = F.meta[r * 1024 + k] * rstd[r] * g; }
    LDS_WAIT(); asm volatile("" ::: "memory");
    const int col = 64 * cchunk + lane; const bool valid = col < PCOLS; const int colc = valid ? col : PCOLS - 1;
    float acc[16];
#pragma unroll
    for (int r = 0; r < 16; ++r) acc[r] = 0.f;
    const float* wp = F.w_in + (size_t)k0 * PCOLS + colc;
#pragma unroll 4
    for (int kk = 0; kk < 128; ++kk) { const float w = wp[(size_t)kk * PCOLS]; const LAS f32x4* u = (const LAS f32x4*)(scr + kk * 16);
#pragma unroll
        for (int q = 0; q < 4; ++q) { const f32x4 a = u[q]; acc[4 * q] += a.x * w; acc[4 * q + 1] += a.y * w; acc[4 * q + 2] += a.z * w; acc[4 * q + 3] += a.w * w; } }
    if (valid) {
#pragma unroll
        for (int r = 0; r < 16; ++r) (void)__hip_atomic_fetch_add(F.MACC + r * PCOLS + col, acc[r], __ATOMIC_RELAXED, __HIP_MEMORY_SCOPE_AGENT); }
    LDS_WAIT(); asm volatile("" ::: "memory");
}
__device__ __forceinline__ void p0_prologue(Frame& F) {
    LAS float* scr = (LAS float*)(F.lds + RING_OFF + F.wave * 16384);
    const int gw = F.vcu * NWAVES + F.wave, NGW = F.G * NWAVES, lane = F.lane;
    constexpr int I_WIN = 16 * 96, I_WOUT = 16 * 32, I_WGU = NEXP * 16 * 32, I_WD = NEXP * 8 * 32, NITEMS = I_WIN + I_WOUT + I_WGU + I_WD;
    for (int it = gw; it < NITEMS; it += NGW) {
        int r = it;
        if (r < I_WIN) { const int kb = r / 96, g = r % 96; p0_transpose_item(F.w_in + win_src_col(g), PCOLS, 1024, F.Win_t + (size_t)(32 * g) * 1024, scr, 64 * kb, lane); continue; } r -= I_WIN;
        if (r < I_WOUT) { const int kb = r / 32, g = r % 32; p0_transpose_item(F.w_out + 32 * g, 1024, 1024, F.Wout_t + (size_t)(32 * g) * 1024, scr, 64 * kb, lane); continue; } r -= I_WOUT;
        if (r < I_WGU) { const int e = r / 512, q = r % 512, kb = q / 32, g = q % 32, j = g >> 3, bj = (g >> 2) & 1, cc = g & 3;
            const float* src = (bj ? F.w_up : F.w_gate) + (size_t)e * 1024 * 512 + 128 * j + 32 * cc;
            p0_transpose_item(src, 512, 1024, F.Wgu_t + ((size_t)e * 1024 + 32 * g) * 1024, scr, 64 * kb, lane); continue; } r -= I_WGU;
        { const int e = r / 256, q = r % 256, kb = q / 32, g = q % 32;
            p0_transpose_item(F.w_down + (size_t)e * 512 * 1024 + 32 * g, 1024, 512, F.Wd_t + ((size_t)e * 1024 + 32 * g) * 512, scr, 64 * kb, lane); }
    }
    {
        float wfg[16][8]; f32x4 gm[4];
#pragma unroll
        for (int j = 0; j < 4; ++j) { gm[j] = *(const GAS f32x4*)(F.gmix + 4 * lane + 256 * j);
#pragma unroll
            for (int i = 0; i < 4; ++i) { const int k = 4 * lane + 256 * j + i; const float g = gm[j][i];
                const f32x4 a = *(const GAS f32x4*)(F.w_in + (size_t)k * PCOLS + 1536), b = *(const GAS f32x4*)(F.w_in + (size_t)k * PCOLS + 1540);
                wfg[4 * j + i][0] = a.x * g; wfg[4 * j + i][1] = a.y * g; wfg[4 * j + i][2] = a.z * g; wfg[4 * j + i][3] = a.w * g;
                wfg[4 * j + i][4] = b.x * g; wfg[4 * j + i][5] = b.y * g; wfg[4 * j + i][6] = b.z * g; wfg[4 * j + i][7] = b.w * g; } }
        const float bfv = F.b_forget[lane & 7];
        for (int m = gw; m < MTOK; m += NGW) {
            const GAS f32x4* xr = (const GAS f32x4*)(F.x + (size_t)m * 1024) + lane;
            f32x4 v[4]; float ss = 0.f;
#pragma unroll
            for (int j = 0; j < 4; ++j) { v[j] = xr[64 * j]; ss += (v[j].x * v[j].x + v[j].y * v[j].y) + (v[j].z * v[j].z + v[j].w * v[j].w); }
            const float rstd = 1.0f / sqrtf(wave_sum(ss) * (1.0f / 1024.0f) + EPS);
            GAS unsigned long long* o8 = (GAS unsigned long long*)(F.XN + (size_t)m * 1024) + lane;
#pragma unroll
            for (int j = 0; j < 4; ++j) { const f32x4 u = v[j] * gm[j] * rstd; o8[64 * j] = (unsigned long long)pk2(u.x, u.y) | ((unsigned long long)pk2(u.z, u.w) << 32); }
            float d[8];
#pragma unroll
            for (int h = 0; h < 8; ++h) { float s = 0.f;
#pragma unroll
                for (int j = 0; j < 4; ++j)
#pragma unroll
                    for (int i = 0; i < 4; ++i) s += v[j][i] * wfg[4 * j + i][h];
                d[h] = wave_sum(s); }
            float mine = d[0];
#pragma unroll
            for (int h = 1; h < 8; ++h) mine = ((lane & 7) == h) ? d[h] : mine;
            if (lane < 8) F.LOGF[(size_t)((m >> 12) * 8 + lane) * TPP + POS0 + (m & 4095)] = log_sigmoid(mine * rstd + bfv);
        }
    }
    if (F.wave < 2) { const int it = F.vcu + F.G * F.wave; if (it < 392) p0_meta_item(F, scr, it); }
    if (F.wave == 2 && F.vcu < 36) { const int e = F.vcu;
        for (int k = lane; k < 1024; k += 64) F.WRG[e * 1024 + k] = F.gffn[k] * (e < 4 ? F.w_rg[k * 4 + e] : F.w_re[k * 32 + (e - 4)]); }
}
__device__ __forceinline__ void p1_meta_finalize(Frame& F) {
    const int bx = blockIdx.x, lane = F.lane, w = F.wave;
    if (bx < 16) { const int r = bx; const float* a = F.MACC + r * PCOLS;
        const float kv = a[512 + 64 * w + lane]; const float ss = wave_sum(kv * kv);
        const float kn = kv * (1.0f / sqrtf(ss * (1.0f / 64.0f) + EPS)) * F.gk[lane];
        const float vv = a[1024 + 64 * w + lane];
        const float uc = a[2056 + 64 * w + lane] * a[2568 + 64 * w + lane];
#pragma unroll
        for (int b = 0; b < BATCH; ++b) { const size_t o = (size_t)(b * TPP + KV0 + r) * 512 + 64 * w + lane;
            F.K[o] = (bf16)f2bf(kn); F.V[o] = (bf16)f2bf(vv); F.UC[o] = (bf16)f2bf(uc); }
        if (w == 0 && lane < 8) { const float lf = log_sigmoid(a[1536 + lane] + F.b_forget[lane]);
#pragma unroll
            for (int b = 0; b < BATCH; ++b) F.LOGF[(size_t)(b * 8 + lane) * TPP + KV0 + r] = lf; }
    } else if (bx < 32) {
        for (int c = (bx - 16) * 512 + F.tid; c < 57344; c += 8192) { const int ts = c / 28672, rem = c % 28672, b = rem / 7168, q = rem % 7168, row = q >> 6, ch = q & 63;
            const int prow = (row < 48) ? row : (TPP - 64) + (row - 48);
            *(GAS v4u*)((ts ? F.V : F.K) + (size_t)(b * TPP + prow) * 512 + ch * 8) = (v4u){0u, 0u, 0u, 0u}; }
    }
}
__device__ __forceinline__ void p2_conv(Frame& F) {
    const int gw = F.vcu * NWAVES + F.wave, NGW = F.G * NWAVES, lane = F.lane, c0 = 8 * lane;
    float w0[8], w1[8], w2[8], go[8];
#pragma unroll
    for (int i = 0; i < 8; ++i) { w0[i] = F.conv_w[c0 + i]; w1[i] = F.conv_w[512 + c0 + i]; w2[i] = F.conv_w[1024 + c0 + i]; go[i] = F.gc[c0 + i]; }
    for (int chunk = gw; chunk < MTOK / 8; chunk += NGW) {
        const int m0 = 8 * chunk; const size_t prow0 = (size_t)(m0 >> 12) * TPP + POS0 + (m0 & 4095);
        float um2[8], um1[8];
        { const v4u a = *(const GAS v4u*)(F.UC + (prow0 - 2) * 512 + c0), b = *(const GAS v4u*)(F.UC + (prow0 - 1) * 512 + c0);
#pragma unroll
          for (int i = 0; i < 4; ++i) { um2[2 * i] = __builtin_bit_cast(float, a[i] << 16); um2[2 * i + 1] = __builtin_bit_cast(float, a[i] & 0xffff0000u);
                                        um1[2 * i] = __builtin_bit_cast(float, b[i] << 16); um1[2 * i + 1] = __builtin_bit_cast(float, b[i] & 0xffff0000u); } }
#pragma unroll 2
        for (int q = 0; q < 8; ++q) {
            const v4u a = *(const GAS v4u*)(F.UC + (prow0 + q) * 512 + c0), b = *(const GAS v4u*)(F.BG + (prow0 + q) * 512 + c0);
            float uc[8], bg[8], cv[8]; float ss = 0.f;
#pragma unroll
            for (int i = 0; i < 4; ++i) { uc[2 * i] = __builtin_bit_cast(float, a[i] << 16); uc[2 * i + 1] = __builtin_bit_cast(float, a[i] & 0xffff0000u);
                                          bg[2 * i] = __builtin_bit_cast(float, b[i] << 16); bg[2 * i + 1] = __builtin_bit_cast(float, b[i] & 0xffff0000u); }
#pragma unroll
            for (int i = 0; i < 8; ++i) { cv[i] = bg[i] * (w0[i] * um2[i] + w1[i] * um1[i] + w2[i] * uc[i]); ss += cv[i] * cv[i]; um2[i] = um1[i]; um1[i] = uc[i]; }
            ss += __shfl_xor(ss, 1); ss += __shfl_xor(ss, 2); ss += __shfl_xor(ss, 4);
            const float rs = 1.0f / sqrtf(ss * (1.0f / 64.0f) + EPS);
            v4u o; o.x = pk2(cv[0] * rs * go[0], cv[1] * rs * go[1]); o.y = pk2(cv[2] * rs * go[2], cv[3] * rs * go[3]); o.z = pk2(cv[4] * rs * go[4], cv[5] * rs * go[5]); o.w = pk2(cv[6] * rs * go[6], cv[7] * rs * go[7]);
            *(GAS v4u*)(F.CAT + (size_t)(m0 + q) * 1024 + 512 + c0) = o;
        }
    }
}
__device__ __forceinline__ void p4_router(Frame& F) {
    const int lane = F.lane, tid = F.tid, wave = F.wave;
    LAS float* lg = (LAS float*)(F.lds + RING_OFF);
    LAS int* re0 = (LAS int*)(F.lds + RING_OFF + 10240); LAS int* re1 = re0 + 64; LAS float* rg0 = (LAS float*)(re1 + 64); LAS float* rg1 = rg0 + 64;
    LAS int* hist = (LAS int*)(rg1 + 64); LAS int* base = hist + 32;
    f32x4 gf[4];
#pragma unroll
    for (int j = 0; j < 4; ++j) gf[j] = *(const GAS f32x4*)(F.gffn + 4 * lane + 256 * j);
    for (int rb = blockIdx.x; rb < MTOK / 64; rb += F.G) {
        if (tid < 32) hist[tid] = 0;
#pragma unroll 1
        for (int pass = 0; pass < 2; ++pass) {
            const int rl0 = wave * 8 + pass * 4, m0 = rb * 64 + rl0;
            f32x4 v[4][4]; float rstd[4];
#pragma unroll
            for (int q = 0; q < 4; ++q) { const GAS f32x4* hr = (const GAS f32x4*)(F.out + (size_t)(m0 + q) * 1024) + lane; float ss = 0.f;
#pragma unroll
                for (int j = 0; j < 4; ++j) { v[q][j] = hr[64 * j]; ss += (v[q][j].x * v[q][j].x + v[q][j].y * v[q][j].y) + (v[q][j].z * v[q][j].z + v[q][j].w * v[q][j].w); }
                rstd[q] = 1.0f / sqrtf(wave_sum(ss) * (1.0f / 1024.0f) + EPS);
                GAS unsigned long long* o8 = (GAS unsigned long long*)(F.XN + (size_t)(m0 + q) * 1024) + lane;
#pragma unroll
                for (int j = 0; j < 4; ++j) { const f32x4 u = v[q][j] * gf[j] * rstd[q]; o8[64 * j] = (unsigned long long)pk2(u.x, u.y) | ((unsigned long long)pk2(u.z, u.w) << 32); } }
#pragma unroll 2
            for (int e = 0; e < 36; ++e) {
                const GAS f32x4* wr = (const GAS f32x4*)(F.WRG + e * 1024) + lane; f32x4 w[4];
#pragma unroll
                for (int j = 0; j < 4; ++j) w[j] = wr[64 * j];
                const float be = (e < 4) ? F.b_rg[e] : F.b_re[e - 4];
#pragma unroll
                for (int q = 0; q < 4; ++q) { float s = 0.f;
#pragma unroll
                    for (int j = 0; j < 4; ++j) s += (v[q][j].x * w[j].x + v[q][j].y * w[j].y) + (v[q][j].z * w[j].z + v[q][j].w * w[j].w);
                    s = wave_sum(s); if (lane == 0) lg[(rl0 + q) * 40 + e] = s * rstd[q] + be; }
            }
        }
        __syncthreads();
        if (tid < 64) { const LAS float* l = lg + tid * 40;
            int gi = 0; float gmx = l[0];
#pragma unroll
            for (int j = 1; j < 4; ++j) { const float t = l[j]; if (t > gmx) { gmx = t; gi = j; } }
            float gs = 0.f;
#pragma unroll
            for (int j = 0; j < 4; ++j) gs += expf(l[j] - gmx);
            const float gp = 1.0f / gs;
            const LAS float* el = l + 4 + 8 * gi;
            int i1 = 0; float l1 = el[0];
#pragma unroll
            for (int j = 1; j < 8; ++j) { const float t = el[j]; if (t > l1) { l1 = t; i1 = j; } }
            int i2 = -1; float l2 = -INFINITY;
#pragma unroll
            for (int j = 0; j < 8; ++j) { const float t = el[j]; if (j != i1 && t > l2) { l2 = t; i2 = j; } }
            const float r = expf(l2 - l1), w1 = 1.0f / (1.0f + r);
            re0[tid] = gi * 8 + i1; re1[tid] = gi * 8 + i2; rg0[tid] = gp * w1; rg1[tid] = gp * r * w1; }
        __syncthreads();
        int e = 0, rank = 0; float gate = 0.f;
        if (tid < 128) { const int row = tid >> 1, k = tid & 1; e = k ? re1[row] : re0[row]; gate = k ? rg1[row] : rg0[row]; rank = __hip_atomic_fetch_add(hist + e, 1, __ATOMIC_RELAXED, __HIP_MEMORY_SCOPE_WORKGROUP); }
        __syncthreads();
        if (tid < 32) { const int c = hist[tid]; base[tid] = c ? (int)__hip_atomic_fetch_add((unsigned*)(F.ctl + CW_CNT + 64 * tid), (unsigned)c, __ATOMIC_RELAXED, __HIP_MEMORY_SCOPE_AGENT) : 0; }
        __syncthreads();
        if (tid < 128) { const int idx = base[e] + rank, m = rb * 64 + (tid >> 1); F.LTOK[e * MTOK + idx] = (m << 1) | (tid & 1); F.LGATE[e * MTOK + idx] = gate; }
        __syncthreads();
    }
}
__device__ __forceinline__ void build_tiles(Frame& F) {
    LAS int* tile_e = (LAS int*)(F.lds + TILE_OFF); LAS int* offs = (LAS int*)(F.lds + OFFS_OFF); LAS int* cnts = offs + 33;
    __syncthreads();
    if (F.tid < 32) cnts[F.tid] = (int)__hip_atomic_load((unsigned*)(F.ctl + CW_CNT + 64 * F.tid), __ATOMIC_RELAXED, __HIP_MEMORY_SCOPE_AGENT);
    __syncthreads();
    if (F.tid == 0) { int off = 0, nt = 0;
        for (int e = 0; e < NEXP; ++e) { offs[e] = off; const int n = (cnts[e] + 255) >> 8; for (int i = 0; i < n; ++i) tile_e[nt + i] = e; nt += n; off += n * 256; }
        offs[32] = nt; }
    __syncthreads();
}
__device__ __forceinline__ void p5_gather(Frame& F) {
    const LAS int* offs = (const LAS int*)(F.lds + OFFS_OFF); const LAS int* cnts = offs + 33;
    const int gw = F.vcu * NWAVES + F.wave, NGW = F.G * NWAVES, lane = F.lane;
    for (int e = 0; e < NEXP; ++e) { const int c = cnts[e], o = offs[e];
        for (int idx = gw; idx < c; idx += NGW) { const int tk = F.LTOK[e * MTOK + idx]; const int slot = o + idx, tok = tk >> 1;
            const GAS v4u* src = (const GAS v4u*)(F.XN + (size_t)tok * 1024) + lane; GAS v4u* dst = (GAS v4u*)(F.XS + (size_t)slot * 1024) + lane;
            const v4u a = src[0], b = src[64]; dst[0] = a; dst[64] = b;
            if (lane == 0) { F.SGATE[slot] = F.LGATE[e * MTOK + idx]; F.SLOTOF[tk] = slot; } } }
}
__device__ __forceinline__ void p8_combine(Frame& F) {
    const int gw = F.vcu * NWAVES + F.wave, NGW = F.G * NWAVES, lane = F.lane;
    for (int m = gw; m < MTOK; m += NGW) { const int s0 = F.SLOTOF[2 * m], s1 = F.SLOTOF[2 * m + 1];
#pragma unroll
        for (int j = 0; j < 2; ++j) { const int c = 8 * lane + 512 * j;
            const v4u a = *(const GAS v4u*)(F.Y + (size_t)s0 * 1024 + c), b = *(const GAS v4u*)(F.Y + (size_t)s1 * 1024 + c);
            GAS f32x4* hp = (GAS f32x4*)(F.out + (size_t)m * 1024 + c); f32x4 h0 = hp[0], h1 = hp[1];
            h0.x += __builtin_bit_cast(float, a.x << 16) + __builtin_bit_cast(float, b.x << 16); h0.y += __builtin_bit_cast(float, a.x & 0xffff0000u) + __builtin_bit_cast(float, b.x & 0xffff0000u);
            h0.z += __builtin_bit_cast(float, a.y << 16) + __builtin_bit_cast(float, b.y << 16); h0.w += __builtin_bit_cast(float, a.y & 0xffff0000u) + __builtin_bit_cast(float, b.y & 0xffff0000u);
            h1.x += __builtin_bit_cast(float, a.z << 16) + __builtin_bit_cast(float, b.z << 16); h1.y += __builtin_bit_cast(float, a.z & 0xffff0000u) + __builtin_bit_cast(float, b.z & 0xffff0000u);
            h1.z += __builtin_bit_cast(float, a.w << 16) + __builtin_bit_cast(float, b.w << 16); h1.w += __builtin_bit_cast(float, a.w & 0xffff0000u) + __builtin_bit_cast(float, b.w & 0xffff0000u);
            hp[0] = h0; hp[1] = h1; } }
}

struct Args { const float* in[19]; float* out; unsigned char* ws; int ph_lo, ph_hi; };
__global__ void __launch_bounds__(NWAVES * 64, 2) skel_fwd(Args args) {
    extern __shared__ __attribute__((aligned(16))) unsigned char lds[];
    Frame F;
    F.lds = (LAS unsigned char*)lds;
    F.MISC = (volatile LAS unsigned*)(F.lds + MISC_OFF);
    F.tid = threadIdx.x; F.lane = F.tid & 63; F.wave = __builtin_amdgcn_readfirstlane(F.tid >> 6);
    F.G = gridDim.x; { const int bx = blockIdx.x; F.vcu = (F.G % 8 == 0) ? (bx % 8) * (F.G / 8) + bx / 8 : bx; }
    unsigned char* ws = args.ws;
    F.ctl = (gu32*)(ws + WS_CTL);
    F.x = args.in[0]; F.meta = args.in[1]; F.gmix = args.in[2]; F.w_in = args.in[3]; F.b_forget = args.in[4]; F.gq = args.in[5]; F.gk = args.in[6]; F.conv_w = args.in[7];
    F.ga = args.in[8]; F.gc = args.in[9]; F.w_out = args.in[10]; F.gffn = args.in[11]; F.w_rg = args.in[12]; F.b_rg = args.in[13]; F.w_re = args.in[14]; F.b_re = args.in[15];
    F.w_gate = args.in[16]; F.w_up = args.in[17]; F.w_down = args.in[18]; F.out = args.out;
    F.Win_t = (bf16*)(ws + WS_WIN); F.Wout_t = (bf16*)(ws + WS_WOUT); F.Wgu_t = (bf16*)(ws + WS_WGU); F.Wd_t = (bf16*)(ws + WS_WD); F.XN = (bf16*)(ws + WS_XN);
    F.Q = (bf16*)(ws + WS_Q); F.K = (bf16*)(ws + WS_K); F.V = (bf16*)(ws + WS_V); F.BG = (bf16*)(ws + WS_BG); F.UC = (bf16*)(ws + WS_UC);
    F.XS = (bf16*)(ws + WS_XS); F.Y = (bf16*)(ws + WS_Y); F.CAT = (bf16*)(ws + WS_CAT); F.HDN = (bf16*)(ws + WS_HDN);
    F.LOGF = (float*)(ws + WS_LOGF); F.WRG = (float*)(ws + WS_WRG); F.LGATE = (float*)(ws + WS_LGATE); F.SGATE = (float*)(ws + WS_SGATE); F.MACC = (float*)(ws + WS_CTL) + CW_MACC;
    F.LTOK = (int*)(ws + WS_LTOK); F.SLOTOF = (int*)(ws + WS_SLOTOF);
    for (int u = F.tid; u < (LDS_BYTES - LDSCTL_OFF) / 4; u += NWAVES * 64) ((LAS unsigned*)(F.lds + LDSCTL_OFF))[u] = 0u;
    __syncthreads();
    XcdBarrier bar; bar.bar = (unsigned*)(F.ctl + CW_BAR); bar.x = 0; bar.st = nullptr;
    if (!MK_SPLIT) bar = xcd_barrier_post((unsigned*)(F.ctl + CW_BAR), F.MISC + 8);
    const int lo = args.ph_lo, hi = args.ph_hi;
#define IN(k) (lo <= (k) && (k) < hi)
#define SEAM(k) do { if (IN(k) && IN((k) + 1)) xcd_barrier(bar); } while (0)

    if (IN(0)) { p0_prologue(F); } SEAM(0);
    if (IN(1)) {
        p1_meta_finalize(F);
        pg8::Gemm g{F.XN, F.Win_t, MTOK, 3072, 1024}; pg8::StaticOrder S; S.init(MTOK, 3072, F.G, (int)blockIdx.x);
        pg8::EpiProj E{F.Q, F.K, F.V, F.BG, F.UC, F.gq, F.gk};
        pg8::gemm_phase<pg8::EpiProj, pg8::StaticOrder, true, true>(F.lds + RING_OFF, g, S, E);
    } SEAM(1);
    if (IN(2)) {
        p2_conv(F);
        const attn_body::AttnTensors AT{(const attn_body::bf16*)F.Q, (const attn_body::bf16*)F.K, (const attn_body::bf16*)F.V, F.LOGF, F.ga, (attn_body::bf16*)F.CAT};
        attn_body::attn_phase<8>((char*)lds + RING_OFF, AT, F.vcu);
    } SEAM(2);
    if (IN(3)) {
        pg8::Gemm g{F.CAT, F.Wout_t, MTOK, 1024, 1024}; pg8::StaticOrder S; S.init(MTOK, 1024, F.G, (int)blockIdx.x);
        pg8::EpiRes E{F.x, F.out};
        pg8::gemm_phase<pg8::EpiRes, pg8::StaticOrder, false, true>(F.lds + RING_OFF, g, S, E);
    } SEAM(3);
    if (IN(4)) { p4_router(F); } SEAM(4);
    if (IN(5)) { build_tiles(F); p5_gather(F); } SEAM(5);
    if (IN(6)) {
        build_tiles(F);
        const LAS int* offs = (const LAS int*)(F.lds + OFFS_OFF);
        pg8::Gemm g{F.XS, F.Wgu_t, 0, 0, 1024}; pg8::GroupedOrder S{4 * offs[32], F.G, (int)blockIdx.x, (const LAS int*)(F.lds + TILE_OFF)};
        pg8::EpiSwiGLU E{F.HDN};
        pg8::gemm_phase<pg8::EpiSwiGLU, pg8::GroupedOrder, true, true>(F.lds + RING_OFF, g, S, E);
    } SEAM(6);
    if (IN(7)) {
        build_tiles(F);
        const LAS int* offs = (const LAS int*)(F.lds + OFFS_OFF);
        pg8::Gemm g{F.HDN, F.Wd_t, 0, 0, 512}; pg8::GroupedOrder S{4 * offs[32], F.G, (int)blockIdx.x, (const LAS int*)(F.lds + TILE_OFF)};
        pg8::EpiDown E{F.Y, F.SGATE};
        pg8::gemm_phase<pg8::EpiDown, pg8::GroupedOrder, true, true>(F.lds + RING_OFF, g, S, E);
    } SEAM(7);
    if (IN(8)) { p8_combine(F); }
#undef IN
#undef SEAM
}

extern "C" void kernel_launch(void* const* d_in, const int* in_sizes, int n_in, void* d_out, int out_size, void* d_ws, size_t ws_size, hipStream_t stream) {
    static int grid = 0;
    if (grid == 0) {
        if (n_in != 19 || in_sizes[0] != MTOK * DMODEL || out_size != MTOK * DMODEL || ws_size < WS_END) { fprintf(stderr, "kernel_launch: unexpected shapes / workspace (n_in %d, ws %zu < %zu); nothing launched\n", n_in, ws_size, (size_t)WS_END); grid = -1; return; }
        int dev = 0, cus = 0;
        if (hipGetDevice(&dev) != hipSuccess || hipDeviceGetAttribute(&cus, hipDeviceAttributeMultiprocessorCount, dev) != hipSuccess) { grid = -1; return; }
        if (hipFuncSetAttribute((const void*)skel_fwd, hipFuncAttributeMaxDynamicSharedMemorySize, LDS_BYTES) != hipSuccess) { fprintf(stderr, "kernel_launch: hipFuncSetAttribute failed\n"); grid = -1; return; }
        (void)hipGetLastError();
        grid = cus;
        if (grid != 256) { fprintf(stderr, "kernel_launch: built for a 256-CU device, found %d CUs; nothing launched\n", cus); grid = -1; return; }
    }
    if (grid < 0) return;
    if (hipMemsetAsync((char*)d_ws + WS_CTL, 0, CTL_ZERO_BYTES, stream) != hipSuccess) return;
    Args a{};
    for (int i = 0; i < 19; ++i) a.in[i] = (const float*)d_in[i];
    a.out = (float*)d_out; a.ws = (unsigned char*)d_ws;
#if MK_SPLIT
    for (int p = 0; p < NPHASE; ++p) { a.ph_lo = p; a.ph_hi = p + 1; hipLaunchKernelGGL(skel_fwd, dim3(grid), dim3(NWAVES * 64), LDS_BYTES, stream, a); }
#else
    a.ph_lo = 0; a.ph_hi = NPHASE;
    hipLaunchKernelGGL(skel_fwd, dim3(grid), dim3(NWAVES * 64), LDS_BYTES, stream, a);
#endif
}
```
